# Optimizing an MI355X kernel written in HIP

```python
import jax, jax.numpy as jnp
from jax import lax
import numpy as np

D_MODEL = 1024
BATCH = 4
SEQ = 4096
DEPTH = 1

CHUNK = 64
FOX_HEAD_DIM = 64
FOX_WIDTH = D_MODEL // 2
FOX_HEADS = FOX_WIDTH // FOX_HEAD_DIM
Q_BLOCK = 128
SGU_WIDTH = D_MODEL // 2
SGU_GROUP_DIM = 64
SGU_GROUPS = SGU_WIDTH // SGU_GROUP_DIM
SGU_WINDOW = 128
N_BRANCHES = 2
D_FF = -(-8 * D_MODEL // (3 * 256)) * 256
EPS = 1e-6
FORGET_BIAS = 2.0

Q_OFF = 0
K_OFF = Q_OFF + FOX_WIDTH
V_OFF = K_OFF + FOX_WIDTH
F_OFF = V_OFF + FOX_WIDTH
U_OFF = F_OFF + FOX_HEADS
G_OFF = U_OFF + 2 * SGU_WIDTH
IN_COLS = G_OFF + N_BRANCHES * D_MODEL

kernel_name = "fox_gmlp_gated_hybrid_block"


def rmsnorm(x, g):
    xf = x.astype(jnp.float32)
    y = xf * lax.rsqrt(jnp.mean(xf * xf, axis=-1, keepdims=True) + EPS)
    return (y * g.astype(jnp.float32)).astype(x.dtype)


def layernorm(x, g, b):
    xf = x.astype(jnp.float32)
    mu = jnp.mean(xf, axis=-1, keepdims=True)
    xc = xf - mu
    y = xc * lax.rsqrt(jnp.mean(xc * xc, axis=-1, keepdims=True) + EPS)
    return (y * g.astype(jnp.float32) + b.astype(jnp.float32)).astype(x.dtype)


def forgetting_attention(q, k, v, log_f):
    s_len = q.shape[2]
    d_cum = jnp.cumsum(log_f, axis=-1)
    scale = FOX_HEAD_DIM ** -0.5
    outs = []
    for i in range(s_len // Q_BLOCK):
        q0, q1 = i * Q_BLOCK, (i + 1) * Q_BLOCK
        qb = q[:, :, q0:q1]
        kb = k[:, :, :q1]
        vb = v[:, :, :q1]
        logits = jnp.einsum('bhqd,bhkd->bhqk', qb, kb).astype(jnp.float32) * scale
        logits = logits + d_cum[:, :, q0:q1, None] - d_cum[:, :, None, :q1]
        q_pos = jnp.arange(q0, q1)[:, None]
        k_pos = jnp.arange(q1)[None, :]
        logits = jnp.where(k_pos <= q_pos, logits, -jnp.inf)
        p = jax.nn.softmax(logits, axis=-1)
        outs.append(jnp.einsum('bhqk,bhkd->bhqd', p.astype(vb.dtype), vb))
    return jnp.concatenate(outs, axis=2)


def spatial_gating(uv, g_norm, b_norm, w_spatial, b_spatial):
    bsz, s_len, _ = uv.shape
    u, v = uv[..., :SGU_WIDTH], uv[..., SGU_WIDTH:]
    v = layernorm(v, g_norm, b_norm)
    v = v.reshape(bsz, s_len // SGU_WINDOW, SGU_WINDOW, SGU_GROUPS, SGU_GROUP_DIM)
    t_idx = jnp.arange(SGU_WINDOW)[:, None]
    s_idx = jnp.arange(SGU_WINDOW)[None, :]
    mask = (s_idx // CHUNK) <= (t_idx // CHUNK)
    ws = jnp.where(mask[None], w_spatial, jnp.zeros((), w_spatial.dtype))
    mixed = jnp.einsum('gts,bnsgc->bntgc', ws, v)
    mixed = mixed + jnp.transpose(b_spatial)[None, None, :, :, None]
    return u * mixed.reshape(bsz, s_len, SGU_WIDTH)


def setup_inputs(seed: int = 0) -> dict:
    key = jax.random.key(seed)
    ks = jax.random.split(key, 20)
    f32 = jnp.float32

    def nrm(k, shape, scale):
        return jax.random.normal(k, shape, f32) * scale

    def gain(k, shape):
        return 1.0 + 0.05 * jax.random.normal(k, shape, f32)

    L = DEPTH
    return {
        "x": jax.random.normal(ks[0], (BATCH, SEQ, D_MODEL), f32),
        "g_pre_mix": gain(ks[1], (L, D_MODEL)),
        "w_in": nrm(ks[2], (L, D_MODEL, IN_COLS), D_MODEL ** -0.5),
        "b_forget": FORGET_BIAS + 0.1 * jax.random.normal(ks[3], (L, FOX_HEADS), f32),
        "g_q": gain(ks[4], (L, FOX_HEAD_DIM)),
        "g_k": gain(ks[5], (L, FOX_HEAD_DIM)),
        "g_sgu": gain(ks[6], (L, SGU_WIDTH)),
        "b_sgu": nrm(ks[7], (L, SGU_WIDTH), 0.02),
        "w_spatial": nrm(ks[8], (L, SGU_GROUPS, SGU_WINDOW, SGU_WINDOW), SGU_WINDOW ** -0.5),
        "b_spatial": 1.0 + 0.05 * jax.random.normal(ks[9], (L, SGU_GROUPS, SGU_WINDOW), f32),
        "w_branch_a": nrm(ks[10], (L, FOX_WIDTH, D_MODEL), FOX_WIDTH ** -0.5),
        "w_branch_b": nrm(ks[11], (L, SGU_WIDTH, D_MODEL), SGU_WIDTH ** -0.5),
        "w_out": nrm(ks[12], (L, D_MODEL, D_MODEL), D_MODEL ** -0.5),
        "g_post_mix": gain(ks[13], (L, D_MODEL)),
        "g_pre_ffn": gain(ks[14], (L, D_MODEL)),
        "w_ffn_in": nrm(ks[15], (L, D_MODEL, 2 * D_FF), D_MODEL ** -0.5),
        "w_ffn_down": nrm(ks[16], (L, D_FF, D_MODEL), D_FF ** -0.5),
        "g_post_ffn": gain(ks[17], (L, D_MODEL)),
    }


def reference(x, g_pre_mix, w_in, b_forget, g_q, g_k, g_sgu, b_sgu, w_spatial, b_spatial,
              w_branch_a, w_branch_b, w_out, g_post_mix, g_pre_ffn, w_ffn_in, w_ffn_down,
              g_post_ffn):
    bsz, s_len, _ = x.shape
    for layer in range(DEPTH):
        h = rmsnorm(x, g_pre_mix[layer])
        proj = h @ w_in[layer]

        def heads(t):
            return t.reshape(bsz, s_len, FOX_HEADS, FOX_HEAD_DIM).transpose(0, 2, 1, 3)

        q = rmsnorm(heads(proj[..., Q_OFF:K_OFF]), g_q[layer])
        k = rmsnorm(heads(proj[..., K_OFF:V_OFF]), g_k[layer])
        v = heads(proj[..., V_OFF:F_OFF])
        f_logit = proj[..., F_OFF:U_OFF].astype(jnp.float32) + b_forget[layer].astype(jnp.float32)
        log_f = jnp.transpose(jax.nn.log_sigmoid(f_logit), (0, 2, 1))
        attn = forgetting_attention(q, k, v, log_f)
        attn = attn.transpose(0, 2, 1, 3).reshape(bsz, s_len, FOX_WIDTH)
        y_a = attn @ w_branch_a[layer]

        uv = jax.nn.gelu(proj[..., U_OFF:G_OFF])
        sgu = spatial_gating(uv, g_sgu[layer], b_sgu[layer], w_spatial[layer], b_spatial[layer])
        y_b = sgu @ w_branch_b[layer]

        gates = jax.nn.sigmoid(proj[..., G_OFF:])
        merged = gates[..., :D_MODEL] * y_a + gates[..., D_MODEL:] * y_b
        x = x + rmsnorm(merged @ w_out[layer], g_post_mix[layer])

        h2 = rmsnorm(x, g_pre_ffn[layer])
        gu = h2 @ w_ffn_in[layer]
        ff = (jax.nn.silu(gu[..., :D_FF]) * gu[..., D_FF:]) @ w_ffn_down[layer]
        x = x + rmsnorm(ff, g_post_ffn[layer])
    return x
```

```cpp
#include <hip/hip_runtime.h>
#include <cstdio>
#include <cmath>

namespace nv {
constexpr int M = 16384, D = 1024, S = 4096, NB = 4, H = 8, HD = 64, INC = 4616, DFF = 2816;
constexpr int Q_OFF = 0, F_OFF = 1536, U_OFF = 1544, G_OFF = 2568;
constexpr float EPS = 1e-6f;
constexpr size_t MiB = 1u << 20;

__device__ __forceinline__ float block_sum256(float v, float* red) {
    for (int o = 32; o > 0; o >>= 1) v += __shfl_xor(v, o);
    const int w = threadIdx.x >> 6;
    __syncthreads();
    if ((threadIdx.x & 63) == 0) red[w] = v;
    __syncthreads();
    return red[0] + red[1] + red[2] + red[3];
}

__global__ void __launch_bounds__(256) k_rmsnorm(const float* x, const float* g, float* y) {
    __shared__ float red[4];
    const size_t row = blockIdx.x;
    const float4 v = ((const float4*)(x + row * D))[threadIdx.x];
    float ss = v.x * v.x + v.y * v.y + v.z * v.z + v.w * v.w;
    ss = block_sum256(ss, red);
    const float r = 1.0f / sqrtf(ss * (1.0f / D) + EPS);
    const float4 gg = ((const float4*)g)[threadIdx.x];
    float4 o; o.x = v.x * r * gg.x; o.y = v.y * r * gg.y; o.z = v.z * r * gg.z; o.w = v.w * r * gg.w;
    ((float4*)(y + row * D))[threadIdx.x] = o;
}

__global__ void __launch_bounds__(256) k_res_rms(const float* base, const float* z, const float* g1, float* out, const float* g2, float* h2) {
    __shared__ float red[4];
    const size_t row = blockIdx.x;
    const float4 v = ((const float4*)(z + row * D))[threadIdx.x];
    float ss = v.x * v.x + v.y * v.y + v.z * v.z + v.w * v.w;
    ss = block_sum256(ss, red);
    const float r = 1.0f / sqrtf(ss * (1.0f / D) + EPS);
    const float4 gg = ((const float4*)g1)[threadIdx.x];
    const float4 b = ((const float4*)(base + row * D))[threadIdx.x];
    float4 o; o.x = b.x + v.x * r * gg.x; o.y = b.y + v.y * r * gg.y; o.z = b.z + v.z * r * gg.z; o.w = b.w + v.w * r * gg.w;
    ((float4*)(out + row * D))[threadIdx.x] = o;
    if (h2) {
        float s2 = o.x * o.x + o.y * o.y + o.z * o.z + o.w * o.w;
        s2 = block_sum256(s2, red);
        const float r2 = 1.0f / sqrtf(s2 * (1.0f / D) + EPS);
        const float4 g2v = ((const float4*)g2)[threadIdx.x];
        float4 h; h.x = o.x * r2 * g2v.x; h.y = o.y * r2 * g2v.y; h.z = o.z * r2 * g2v.z; h.w = o.w * r2 * g2v.w;
        ((float4*)(h2 + row * D))[threadIdx.x] = h;
    }
}

enum { EPI_STORE = 0, EPI_SIGMOID, EPI_GELU, EPI_MUL_C, EPI_FMA_GATE, EPI_SILU_MUL };
__device__ __forceinline__ float gelu_tanh(float x) { return 0.5f * x * (1.0f + tanhf(0.7978845608028654f * (x + 0.044715f * x * x * x))); }
__device__ __forceinline__ float sigmoidf_(float x) { return 1.0f / (1.0f + expf(-x)); }

template <int EPI>
__global__ void __launch_bounds__(256) k_gemm(const float* A, int lda, const float* Bm, int ldb, float* C, int ldc, int N, int K, const float* G, int ldg) {
    __shared__ float As[16][68];
    __shared__ float Bs[16][68];
    const int t = threadIdx.x, tx = t & 15, ty = t >> 4;
    const int m0 = blockIdx.y * 64, n0 = blockIdx.x * 64;
    float acc[4][4];
#pragma unroll
    for (int i = 0; i < 4; ++i)
#pragma unroll
        for (int j = 0; j < 4; ++j) acc[i][j] = 0.f;
    const int ar = t >> 2, ak = (t & 3) * 4;
    const int bk = t >> 4, bc = (t & 15) * 4;
    for (int k0 = 0; k0 < K; k0 += 16) {
        const float4 av = *(const float4*)(A + (size_t)(m0 + ar) * lda + k0 + ak);
        float4 bv;
        const float* bp = Bm + (size_t)(k0 + bk) * ldb + n0 + bc;
        if (n0 + bc + 3 < N) bv = *(const float4*)bp;
        else { bv.x = (n0 + bc + 0 < N) ? bp[0] : 0.f; bv.y = (n0 + bc + 1 < N) ? bp[1] : 0.f; bv.z = (n0 + bc + 2 < N) ? bp[2] : 0.f; bv.w = 0.f; }
        __syncthreads();
        As[ak + 0][ar] = av.x; As[ak + 1][ar] = av.y; As[ak + 2][ar] = av.z; As[ak + 3][ar] = av.w;
        Bs[bk][bc + 0] = bv.x; Bs[bk][bc + 1] = bv.y; Bs[bk][bc + 2] = bv.z; Bs[bk][bc + 3] = bv.w;
        __syncthreads();
#pragma unroll
        for (int kk = 0; kk < 16; ++kk) {
            const float4 a = *(const float4*)&As[kk][ty * 4];
            const float4 b = *(const float4*)&Bs[kk][tx * 4];
            const float aa[4] = {a.x, a.y, a.z, a.w}, bb[4] = {b.x, b.y, b.z, b.w};
#pragma unroll
            for (int i = 0; i < 4; ++i)
#pragma unroll
                for (int j = 0; j < 4; ++j) acc[i][j] += aa[i] * bb[j];
        }
    }
#pragma unroll
    for (int i = 0; i < 4; ++i)
#pragma unroll
        for (int j = 0; j < 4; ++j) {
            const int row = m0 + ty * 4 + i, col = n0 + tx * 4 + j;
            if (col < N) {
                float* cp = C + (size_t)row * ldc + col;
                const float a = acc[i][j];
                float o;
                if (EPI == EPI_STORE) o = a;
                else if (EPI == EPI_SIGMOID) o = sigmoidf_(a);
                else if (EPI == EPI_GELU) o = gelu_tanh(a);
                else if (EPI == EPI_MUL_C) o = *cp * a;
                else if (EPI == EPI_FMA_GATE) o = *cp + G[(size_t)row * ldg + col] * a;
                else { const float c = *cp; o = c * sigmoidf_(c) * a; }
                *cp = o;
            }
        }
}

__global__ void k_qknorm(float* qkv, const float* gq, const float* gk) {
    const int idx = blockIdx.x * blockDim.x + threadIdx.x;
    if (idx >= M * 16) return;
    const int row = idx >> 4, hw = idx & 15, which = hw >> 3, h = hw & 7;
    float* p = qkv + (size_t)row * 1536 + which * 512 + h * 64;
    const float* g = which ? gk : gq;
    float ss = 0.f;
    for (int i = 0; i < 64; ++i) ss += p[i] * p[i];
    const float r = 1.0f / sqrtf(ss * (1.0f / 64) + EPS);
    for (int i = 0; i < 64; ++i) p[i] = p[i] * r * g[i];
}

__global__ void k_logf_cumsum(const float* FL, const float* bf, float* Dc) {
    const int bh = threadIdx.x; if (bh >= NB * H) return;
    const int b = bh / H, h = bh % H;
    float acc = 0.f;
    for (int s = 0; s < S; ++s) {
        const float z = FL[(size_t)(b * S + s) * 8 + h] + bf[h];
        const float ls = z < 0.f ? z - log1pf(expf(z)) : -log1pf(expf(-z));
        acc += ls;
        Dc[(size_t)bh * S + s] = acc;
    }
}

__global__ void __launch_bounds__(64) k_attn(const float* qkv, const float* Dc, float* attn) {
    const int q = blockIdx.x * 64 + threadIdx.x;
    const int bh = blockIdx.y, b = bh / H, h = bh % H;
    const float* Qp = qkv + (size_t)(b * S + q) * 1536 + h * 64;
    float qv[64], o[64];
#pragma unroll
    for (int i = 0; i < 64; ++i) { qv[i] = Qp[i] * 0.125f; o[i] = 0.f; }
    const float dq = Dc[(size_t)bh * S + q];
    float m = -INFINITY, l = 0.f;
    const int kmax = blockIdx.x * 64 + 63;
    for (int k = 0; k <= kmax; ++k) {
        const float* Kp = qkv + (size_t)(b * S + k) * 1536 + 512 + h * 64;
        const float* Vp = Kp + 512;
        float s = 0.f;
#pragma unroll
        for (int i = 0; i < 64; ++i) s += qv[i] * Kp[i];
        s += dq - Dc[(size_t)bh * S + k];
        if (k <= q) {
            const float mn = fmaxf(m, s);
            const float sc = expf(m - mn), p = expf(s - mn);
            l = l * sc + p;
#pragma unroll
            for (int i = 0; i < 64; ++i) o[i] = o[i] * sc + p * Vp[i];
            m = mn;
        }
    }
    const float inv = 1.0f / l;
    float* Op = attn + (size_t)(b * S + q) * 512 + h * 64;
#pragma unroll
    for (int i = 0; i < 64; ++i) Op[i] = o[i] * inv;
}

__global__ void __launch_bounds__(64) k_ln_v(float* uv, const float* g, const float* bb) {
    const size_t row = blockIdx.x;
    float* p = uv + row * 1024 + 512;
    float v[8]; float s = 0.f;
#pragma unroll
    for (int i = 0; i < 8; ++i) { v[i] = p[threadIdx.x + 64 * i]; s += v[i]; }
    for (int o = 32; o > 0; o >>= 1) s += __shfl_xor(s, o);
    const float mu = s * (1.0f / 512);
    float q = 0.f;
#pragma unroll
    for (int i = 0; i < 8; ++i) { v[i] -= mu; q += v[i] * v[i]; }
    for (int o = 32; o > 0; o >>= 1) q += __shfl_xor(q, o);
    const float r = 1.0f / sqrtf(q * (1.0f / 512) + EPS);
#pragma unroll
    for (int i = 0; i < 8; ++i) { const int c = threadIdx.x + 64 * i; p[c] = v[i] * r * g[c] + bb[c]; }
}

__global__ void __launch_bounds__(256) k_sgu(const float* uv, const float* ws, const float* bsp, float* sgu) {
    const size_t idx = (size_t)blockIdx.x * 256 + threadIdx.x;
    const int tok = (int)(idx >> 9), c = (int)(idx & 511);
    const int g = c >> 6, t = tok & 127, base = tok - t;
    const int smax = (t < 64) ? 64 : 128;
    const float* w = ws + ((size_t)g * 128 + t) * 128;
    float acc = 0.f;
    for (int s = 0; s < smax; ++s) acc += w[s] * uv[(size_t)(base + s) * 1024 + 512 + c];
    acc += bsp[g * 128 + t];
    sgu[(size_t)tok * 512 + c] = uv[(size_t)tok * 1024 + c] * acc;
}

template <int EPI>
static void gemm(hipStream_t st, const float* A, int lda, const float* Bm, int ldb, float* C, int ldc, int N, int K, const float* G = nullptr, int ldg = 0) {
    dim3 grid((N + 63) / 64, M / 64);
    hipLaunchKernelGGL(k_gemm<EPI>, grid, dim3(256), 0, st, A, lda, Bm, ldb, C, ldc, N, K, G, ldg);
}

static void forward(void* const* d_in, float* out, unsigned char* ws, hipStream_t st) {
    const float* x = (const float*)d_in[0];
    const float* g_pre_mix = (const float*)d_in[1];
    const float* w_in = (const float*)d_in[2];
    const float* b_forget = (const float*)d_in[3];
    const float* g_q = (const float*)d_in[4];
    const float* g_k = (const float*)d_in[5];
    const float* g_sgu = (const float*)d_in[6];
    const float* b_sgu = (const float*)d_in[7];
    const float* w_spatial = (const float*)d_in[8];
    const float* b_spatial = (const float*)d_in[9];
    const float* w_branch_a = (const float*)d_in[10];
    const float* w_branch_b = (const float*)d_in[11];
    const float* w_out = (const float*)d_in[12];
    const float* g_post_mix = (const float*)d_in[13];
    const float* g_pre_ffn = (const float*)d_in[14];
    const float* w_ffn_in = (const float*)d_in[15];
    const float* w_ffn_down = (const float*)d_in[16];
    const float* g_post_ffn = (const float*)d_in[17];

    float* hbuf = (float*)(ws + 0 * MiB);
    float* QKV = (float*)(ws + 64 * MiB);
    float* ATT = (float*)(ws + 224 * MiB);
    float* UV = (float*)(ws + 64 * MiB);
    float* SGU = (float*)(ws + 128 * MiB);
    float* X = (float*)(ws + 64 * MiB);
    float* Y = (float*)(ws + 160 * MiB);
    float* GU = (float*)(ws + 64 * MiB);
    float* FL = out;
    float* Dc = out + (size_t)M * 8;

    hipLaunchKernelGGL(k_rmsnorm, dim3(M), dim3(256), 0, st, x, g_pre_mix, hbuf);
    gemm<EPI_STORE>(st, hbuf, D, w_in + Q_OFF, INC, QKV, 1536, 1536, D);
    gemm<EPI_STORE>(st, hbuf, D, w_in + F_OFF, INC, FL, 8, 8, D);
    hipLaunchKernelGGL(k_qknorm, dim3(M * 16 / 256), dim3(256), 0, st, QKV, g_q, g_k);
    hipLaunchKernelGGL(k_logf_cumsum, dim3(1), dim3(64), 0, st, FL, b_forget, Dc);
    hipLaunchKernelGGL(k_attn, dim3(S / 64, NB * H), dim3(64), 0, st, QKV, Dc, ATT);
    gemm<EPI_GELU>(st, hbuf, D, w_in + U_OFF, INC, UV, 1024, 1024, D);
    hipLaunchKernelGGL(k_ln_v, dim3(M), dim3(64), 0, st, UV, g_sgu, b_sgu);
    hipLaunchKernelGGL(k_sgu, dim3(M * 512 / 256), dim3(256), 0, st, UV, w_spatial, b_spatial, SGU);
    gemm<EPI_SIGMOID>(st, hbuf, D, w_in + G_OFF, INC, X, 1024, 1024, D);
    gemm<EPI_MUL_C>(st, ATT, 512, w_branch_a, D, X, 1024, 1024, 512);
    gemm<EPI_SIGMOID>(st, hbuf, D, w_in + G_OFF + 1024, INC, Y, 1024, 1024, D);
    gemm<EPI_FMA_GATE>(st, SGU, 512, w_branch_b, D, X, 1024, 1024, 512, Y, 1024);
    gemm<EPI_STORE>(st, X, D, w_out, D, Y, 1024, 1024, D);
    hipLaunchKernelGGL(k_res_rms, dim3(M), dim3(256), 0, st, x, Y, g_post_mix, out, g_pre_ffn, hbuf);
    gemm<EPI_STORE>(st, hbuf, D, w_ffn_in, 2 * DFF, GU, DFF, DFF, D);
    gemm<EPI_SILU_MUL>(st, hbuf, D, w_ffn_in + DFF, 2 * DFF, GU, DFF, DFF, D);
    gemm<EPI_STORE>(st, GU, DFF, w_ffn_down, D, hbuf, 1024, 1024, DFF);
    hipLaunchKernelGGL(k_res_rms, dim3(M), dim3(256), 0, st, (const float*)out, hbuf, g_post_ffn, out, (const float*)nullptr, (float*)nullptr);
}
}

extern "C" void kernel_launch(void* const* d_in, const int* in_sizes, int n_in, void* d_out, int out_size, void* d_ws, size_t ws_size, hipStream_t stream) {
    if (n_in != 18 || out_size != nv::M * nv::D || ws_size < 256 * nv::MiB) { fprintf(stderr, "kernel_launch: unexpected shapes n_in %d out %d ws %zu\n", n_in, out_size, ws_size); return; }
    nv::forward(d_in, (float*)d_out, (unsigned char*)d_ws, stream);
}
```
